# Optimizing an MI355X kernel written in HIP

```python
import jax, jax.numpy as jnp
from jax import lax
import numpy as np

D_MODEL = 1024
BATCH = 32
SEQ = 256
DEPTH = 1
DEC_BATCH = 8
DEC_SEQ = 1024
PAST_LEN = 512

GRID_W = 64
HEAD_DIM = 64
ATTN_SCALE = HEAD_DIM ** -0.5
EPS = 1e-6
NA_HEADS = 8
NA_WIDTH = NA_HEADS * HEAD_DIM
NA_KH = 8
NA_KW = 16
NA_QCB = 16
NA_KCB = 32
NA_NCB = GRID_W // NA_QCB
WA_Q_HEADS = 8
WA_KV_HEADS = 2
WA_GROUP = WA_Q_HEADS // WA_KV_HEADS
WA_WIDTH = WA_Q_HEADS * HEAD_DIM
WA_KV_WIDTH = WA_KV_HEADS * HEAD_DIM
WINDOW = 128
WA_BLOCK = 128
ROPE_HALF = HEAD_DIM // 2
ROPE_BASE = 10000.0
IN_SPLITS = (NA_WIDTH, NA_WIDTH, NA_WIDTH, NA_WIDTH,
             WA_WIDTH, WA_KV_WIDTH, WA_KV_WIDTH, WA_WIDTH,
             D_MODEL, D_MODEL)
D_IN = 4 * NA_WIDTH + 2 * WA_WIDTH + 2 * WA_KV_WIDTH + 2 * D_MODEL

kernel_name = "hybrid_natten_swa_diffusion_step"


def _rmsnorm(x):
    xf = x.astype(jnp.float32)
    return (xf * lax.rsqrt(jnp.mean(xf * xf, axis=-1, keepdims=True) + EPS)).astype(x.dtype)


def _modulation(cvec, w_ada, b_ada):
    m = jax.nn.silu(cvec) @ w_ada + b_ada
    return m[..., :D_MODEL], m[..., D_MODEL:2 * D_MODEL], m[..., 2 * D_MODEL:]


def _project(x, shift, scale, w_in):
    h = _rmsnorm(x) * (1.0 + scale) + shift
    p = h @ w_in
    outs, off = [], 0
    for w in IN_SPLITS:
        outs.append(p[..., off:off + w])
        off += w
    return outs


def _merge(x, oa, za, ob, zb, ga, gb, gate, w_br_a, w_br_b, w_out):
    ya = (oa * jax.nn.silu(za)) @ w_br_a
    yb = (ob * jax.nn.silu(zb)) @ w_br_b
    h = jax.nn.sigmoid(ga) * ya + jax.nn.sigmoid(gb) * yb
    return x + gate * (h @ w_out)


def _softmax_f32(s):
    return jax.nn.softmax(s.astype(jnp.float32), axis=-1)


def _axial_rope(x):
    T = x.shape[1]
    t = jnp.arange(T)
    row = (t // GRID_W).astype(jnp.float32)
    col = (t % GRID_W).astype(jnp.float32)
    inv = ROPE_BASE ** (-jnp.arange(0, ROPE_HALF, 2, dtype=jnp.float32) / ROPE_HALF)
    n = ROPE_HALF // 2

    def rot(xh, pos):
        ang = pos[:, None] * inv[None, :]
        cos = jnp.cos(ang)[:, None, :].astype(x.dtype)
        sin = jnp.sin(ang)[:, None, :].astype(x.dtype)
        x1, x2 = xh[..., :n], xh[..., n:]
        return jnp.concatenate([x1 * cos - x2 * sin, x1 * sin + x2 * cos], axis=-1)

    return jnp.concatenate([rot(x[..., :ROPE_HALF], row), rot(x[..., ROPE_HALF:], col)], axis=-1)


def _dense_attn(q, k, v):
    s = jnp.einsum('bqhd,bkhd->bhqk', q, k).astype(jnp.float32) * ATTN_SCALE
    p = _softmax_f32(s).astype(v.dtype)
    o = jnp.einsum('bhqk,bkhd->bqhd', p, v)
    return o.reshape(q.shape[0], q.shape[1], -1)


def _dense_sink_gqa(q, k, v, sink):
    s = jnp.einsum('bqkgd,bskd->bkgqs', q, k).astype(jnp.float32) * ATTN_SCALE
    sink_col = jnp.broadcast_to(sink.reshape(WA_KV_HEADS, WA_GROUP)[None, :, :, None, None].astype(jnp.float32),
                                s.shape[:-1] + (1,))
    p = _softmax_f32(jnp.concatenate([s, sink_col], axis=-1))[..., :-1].astype(v.dtype)
    o = jnp.einsum('bkgqs,bskd->bqkgd', p, v)
    return o.reshape(q.shape[0], q.shape[1], -1)


def _neighbourhood_attn(q, k, v, ck, cv, rpb):
    B, T, H, Dh = q.shape
    rows = T // GRID_W
    kh = min(NA_KH, rows)
    r = jnp.arange(rows)
    row_start = jnp.clip(r - kh // 2, 0, rows - kh)
    row_idx = row_start[:, None] + jnp.arange(kh)
    j = jnp.arange(NA_NCB)
    kcol_start = jnp.clip(j * NA_QCB - (NA_KCB - NA_QCB) // 2, 0, GRID_W - NA_KCB)
    kcol_idx = kcol_start[:, None] + jnp.arange(NA_KCB)
    qcol = j[:, None] * NA_QCB + jnp.arange(NA_QCB)
    win_start = jnp.clip(qcol - NA_KW // 2, 0, GRID_W - NA_KW)
    kc = kcol_idx[:, None, :]
    col_ok = (kc >= win_start[..., None]) & (kc < win_start[..., None] + NA_KW)
    dr = row_idx - r[:, None]
    dc = jnp.clip(kc - qcol[..., None], -(NA_KW - 1), NA_KW - 1)
    bias = rpb[:, dr[:, None, None, :, None] + NA_KH - 1, dc[None, :, :, None, :] + NA_KW - 1]
    bias = bias.astype(jnp.float32)
    bias = jnp.where(col_ok[None, None, :, :, None, :], bias, -jnp.inf)
    bias = bias.transpose(1, 2, 0, 3, 4, 5).reshape(rows, NA_NCB, H, NA_QCB, kh * NA_KCB)

    qg = q.reshape(B, rows, NA_NCB, NA_QCB, H, Dh)
    kgrid = k.reshape(B, rows, GRID_W, H, Dh)
    vgrid = v.reshape(B, rows, GRID_W, H, Dh)
    ri = row_idx[:, None, :, None]
    ci = kcol_idx[None, :, None, :]
    kb = kgrid[:, ri, ci].reshape(B, rows, NA_NCB, kh * NA_KCB, H, Dh)
    vb = vgrid[:, ri, ci].reshape(B, rows, NA_NCB, kh * NA_KCB, H, Dh)

    s_nb = jnp.einsum('brjqhd,brjkhd->brjhqk', qg, kb).astype(jnp.float32) * ATTN_SCALE + bias[None]
    s_ctx = jnp.einsum('brjqhd,bshd->brjhqs', qg, ck).astype(jnp.float32) * ATTN_SCALE
    p = _softmax_f32(jnp.concatenate([s_nb, s_ctx], axis=-1)).astype(v.dtype)
    nk = kh * NA_KCB
    o = (jnp.einsum('brjhqk,brjkhd->brjqhd', p[..., :nk], vb)
         + jnp.einsum('brjhqs,bshd->brjqhd', p[..., nk:], cv))
    return o.reshape(B, T, H * Dh)


def _window_sink_gqa(q, k, v, ck, cv, sink):
    B, T = q.shape[0], q.shape[1]
    nb = T // WA_BLOCK
    P = ck.shape[1]
    qb = q.reshape(B, nb, WA_BLOCK, WA_KV_HEADS, WA_GROUP, HEAD_DIM)
    pad = ((0, 0), (WA_BLOCK, WA_BLOCK), (0, 0), (0, 0))
    kp = jnp.pad(k, pad).reshape(B, nb + 2, WA_BLOCK, WA_KV_HEADS, HEAD_DIM)
    vp = jnp.pad(v, pad).reshape(B, nb + 2, WA_BLOCK, WA_KV_HEADS, HEAD_DIM)
    kband = jnp.concatenate([kp[:, :-2], kp[:, 1:-1], kp[:, 2:]], axis=2)
    vband = jnp.concatenate([vp[:, :-2], vp[:, 1:-1], vp[:, 2:]], axis=2)
    blk = jnp.arange(nb)
    qpos = blk[:, None] * WA_BLOCK + jnp.arange(WA_BLOCK)
    kpos = blk[:, None] * WA_BLOCK - WA_BLOCK + jnp.arange(3 * WA_BLOCK)
    ok = ((jnp.abs(kpos[:, None, :] - qpos[:, :, None]) <= WINDOW)
          & (kpos >= 0)[:, None, :] & (kpos < T)[:, None, :])
    s_nb = jnp.einsum('bnqkgd,bnskd->bnkgqs', qb, kband).astype(jnp.float32) * ATTN_SCALE
    s_nb = jnp.where(ok[None, :, None, None], s_nb, -jnp.inf)
    s_ctx = jnp.einsum('bnqkgd,bskd->bnkgqs', qb, ck).astype(jnp.float32) * ATTN_SCALE
    sink_col = jnp.broadcast_to(sink.reshape(WA_KV_HEADS, WA_GROUP)[None, None, :, :, None, None].astype(jnp.float32),
                                s_nb.shape[:-1] + (1,))
    p = _softmax_f32(jnp.concatenate([s_nb, s_ctx, sink_col], axis=-1)).astype(v.dtype)
    nk = 3 * WA_BLOCK
    o = (jnp.einsum('bnkgqs,bnskd->bnqkgd', p[..., :nk], vband)
         + jnp.einsum('bnkgqs,bskd->bnqkgd', p[..., nk:nk + P], cv))
    return o.reshape(B, T, WA_WIDTH)


def _context_layer(x, c_ctx, w_ada, b_ada, w_in, sink, w_br_a, w_br_b, w_out):
    B, S, _ = x.shape
    shift, scale, gate = _modulation(c_ctx, w_ada, b_ada)
    qa, ka, va, za, qb, kb, vb, zb, ga, gb = _project(x, shift, scale, w_in)
    qa = qa.reshape(B, S, NA_HEADS, HEAD_DIM)
    ka = ka.reshape(B, S, NA_HEADS, HEAD_DIM)
    va = va.reshape(B, S, NA_HEADS, HEAD_DIM)
    qb = qb.reshape(B, S, WA_KV_HEADS, WA_GROUP, HEAD_DIM)
    kb = kb.reshape(B, S, WA_KV_HEADS, HEAD_DIM)
    vb = vb.reshape(B, S, WA_KV_HEADS, HEAD_DIM)
    oa = _dense_attn(qa, ka, va)
    ob = _dense_sink_gqa(qb, kb, vb, sink)
    y = _merge(x, oa, za, ob, zb, ga, gb, gate, w_br_a, w_br_b, w_out)
    return y, ka, va, kb, vb


def _latent_layer(x, c, ck_a, cv_a, ck_b, cv_b, w_ada, b_ada, w_in, rpb, sink, w_br_a, w_br_b, w_out):
    B, T, _ = x.shape
    shift, scale, gate = _modulation(c, w_ada, b_ada)
    qa, ka, va, za, qb, kb, vb, zb, ga, gb = _project(x, shift[:, None], scale[:, None], w_in)
    qa = qa.reshape(B, T, NA_HEADS, HEAD_DIM)
    ka = ka.reshape(B, T, NA_HEADS, HEAD_DIM)
    va = va.reshape(B, T, NA_HEADS, HEAD_DIM)
    qb = _axial_rope(qb.reshape(B, T, WA_Q_HEADS, HEAD_DIM)).reshape(B, T, WA_KV_HEADS, WA_GROUP, HEAD_DIM)
    kb = _axial_rope(kb.reshape(B, T, WA_KV_HEADS, HEAD_DIM))
    vb = vb.reshape(B, T, WA_KV_HEADS, HEAD_DIM)
    oa = _neighbourhood_attn(qa, ka, va, ck_a, cv_a, rpb)
    ob = _window_sink_gqa(qb, kb, vb, ck_b, cv_b, sink)
    return _merge(x, oa, za, ob, zb, ga, gb, gate[:, None], w_br_a, w_br_b, w_out)


def setup_inputs(seed: int = 0) -> dict:
    key = jax.random.key(seed)
    ks = jax.random.split(key, 20)
    f32 = jnp.float32
    nrm = lambda k, shp, s: jax.random.normal(k, shp, f32) * s
    return {
        "x_prompt": nrm(ks[0], (BATCH, SEQ, D_MODEL), 1.0),
        "x_sample": nrm(ks[1], (DEC_BATCH, DEC_SEQ, D_MODEL), 1.0),
        "cache_a_k": nrm(ks[2], (DEC_BATCH, DEPTH, PAST_LEN, NA_HEADS, HEAD_DIM), 1.0),
        "cache_a_v": nrm(ks[3], (DEC_BATCH, DEPTH, PAST_LEN, NA_HEADS, HEAD_DIM), 1.0),
        "cache_b_k": nrm(ks[4], (DEC_BATCH, DEPTH, PAST_LEN, WA_KV_HEADS, HEAD_DIM), 1.0),
        "cache_b_v": nrm(ks[5], (DEC_BATCH, DEPTH, PAST_LEN, WA_KV_HEADS, HEAD_DIM), 1.0),
        "c": nrm(ks[6], (DEC_BATCH, D_MODEL), 1.0),
        "c_ctx": nrm(ks[7], (D_MODEL,), 1.0),
        "w_ada": nrm(ks[8], (DEPTH, D_MODEL, 3 * D_MODEL), D_MODEL ** -0.5),
        "b_ada": nrm(ks[9], (DEPTH, 3 * D_MODEL), 0.02),
        "w_in": nrm(ks[10], (DEPTH, D_MODEL, D_IN), D_MODEL ** -0.5),
        "rpb_a": nrm(ks[11], (DEPTH, NA_HEADS, 2 * NA_KH - 1, 2 * NA_KW - 1), 0.1),
        "sink_b": nrm(ks[12], (DEPTH, WA_Q_HEADS), 0.5),
        "w_br_a": nrm(ks[13], (DEPTH, NA_WIDTH, D_MODEL), NA_WIDTH ** -0.5),
        "w_br_b": nrm(ks[14], (DEPTH, WA_WIDTH, D_MODEL), WA_WIDTH ** -0.5),
        "w_out": nrm(ks[15], (DEPTH, D_MODEL, D_MODEL), D_MODEL ** -0.5),
        "final_norm_g": 1.0 + nrm(ks[16], (D_MODEL,), 0.02),
    }


def reference(x_prompt, x_sample, cache_a_k, cache_a_v, cache_b_k, cache_b_v, c, c_ctx,
              w_ada, b_ada, w_in, rpb_a, sink_b, w_br_a, w_br_b, w_out, final_norm_g):
    xp, xs = x_prompt, x_sample
    new_ak, new_av, new_bk, new_bv = [], [], [], []
    for l in range(DEPTH):
        xp, ka, va, kb, vb = _context_layer(xp, c_ctx, w_ada[l], b_ada[l], w_in[l], sink_b[l],
                                            w_br_a[l], w_br_b[l], w_out[l])
        new_ak.append(ka)
        new_av.append(va)
        new_bk.append(kb)
        new_bv.append(vb)
        xs = _latent_layer(xs, c, cache_a_k[:, l], cache_a_v[:, l], cache_b_k[:, l], cache_b_v[:, l],
                           w_ada[l], b_ada[l], w_in[l], rpb_a[l], sink_b[l], w_br_a[l], w_br_b[l], w_out[l])
    y_prompt = _rmsnorm(xp) * final_norm_g
    y_sample = _rmsnorm(xs) * final_norm_g
    new_a_k = jnp.stack(new_ak, axis=1)
    new_a_v = jnp.stack(new_av, axis=1)
    new_b_k = jnp.stack(new_bk, axis=1)
    new_b_v = jnp.stack(new_bv, axis=1)
    return (y_prompt, y_sample, new_a_k, new_a_v, new_b_k, new_b_v)
```

```cpp
#include <hip/hip_runtime.h>
#include <hip/hip_bf16.h>
#include <cstdio>
#include <cstdint>
#include <cmath>

#ifndef MK_N_LAUNCHES
#define MK_N_LAUNCHES 7
#endif

constexpr int DM = 1024, MROWS = 16384, MCTX = 8192, DIN = 5376;
constexpr float LOG2E = 1.4426950408889634f;
constexpr float C2 = 0.125f * LOG2E;
constexpr float EPS = 1e-6f;

namespace pg8 {
#define PG8_LAS __attribute__((address_space(3)))
typedef unsigned short bf16_t;
typedef short bf16x8 __attribute__((ext_vector_type(8)));
typedef float f32x4 __attribute__((ext_vector_type(4)));
typedef unsigned u32x4 __attribute__((ext_vector_type(4)));
typedef unsigned u32x2 __attribute__((ext_vector_type(2)));
constexpr int BM = 256, BK = 64, HALF = 128, HTB = HALF * BK * 2, STAGE_BYTES = 8 * HTB, NXCD = 8, WGM = 8;

__host__ __device__ __forceinline__ int lds_byte(int r, int c) { const int st = (r >> 4) * 2 + (c >> 5), rr = r & 15, cc = c & 31, ob = rr * 64 + cc * 2; return st * 1024 + (ob ^ (((ob >> 9) & 1) << 5)); }
__host__ __device__ __forceinline__ void stage_rc(int b, int& R, int& C) { const int st = b / 1024, sb = b % 1024, swz = sb ^ (((sb >> 9) & 1) << 5); R = (st >> 1) * 16 + swz / 64; C = (st & 1) * 32 + (swz % 64) / 2; }
__host__ __device__ __forceinline__ int perm32(int rho) { const int n = rho >> 4, i = rho & 15; return 8 * (i >> 2) + 4 * n + (i & 3); }

struct Unit { int pm, pn, s; const char* Ab; const char* Bb; };
struct GemmCfg { int lda, ldb, K; };

__device__ __forceinline__ void tile_of(int L, int nM, int nN, int& pm, int& pn) {
    const int nwg = nM * nN; int wgid = L; { const int q = nwg / NXCD, r = nwg % NXCD, xcd = wgid % NXCD, off = wgid / NXCD; wgid = (xcd < r ? xcd * (q + 1) : r * (q + 1) + (xcd - r) * q) + off; }
    const int nig = WGM * nN, gid = wgid / nig, fm = gid * WGM, gsz = (nM - fm) < WGM ? (nM - fm) : WGM;
    pm = fm + ((wgid % nig) % gsz); pn = (wgid % nig) / gsz;
}

__device__ __forceinline__ unsigned cvt_pk_bf16(float lo, float hi) { typedef float f2 __attribute__((ext_vector_type(2))); typedef __bf16 b2 __attribute__((ext_vector_type(2))); f2 v = {lo, hi}; b2 b = __builtin_convertvector(v, b2); return __builtin_bit_cast(unsigned, b); }
__device__ __forceinline__ float bf_lo(unsigned w) { return __uint_as_float(w << 16); }
__device__ __forceinline__ float bf_hi(unsigned w) { return __uint_as_float(w & 0xffff0000u); }
__device__ __forceinline__ float sigmoidf_(float x) { return __builtin_amdgcn_rcpf(1.0f + __builtin_amdgcn_exp2f(-LOG2E * x)); }

typedef f32x4 Acc[2][2][4][2];

template <int ACT  >
__device__ __forceinline__ void epi_bf16(const Acc& acc, int bj_lo, int bj_hi, bf16_t* dst, int ld, int row0, int col0, float sc) {
#pragma unroll
    for (int ai = 0; ai < 2; ++ai)
#pragma unroll
        for (int m = 0; m < 4; ++m) { bf16_t* rowp = dst + (size_t)(row0 + ai * HALF + m * 16) * ld + col0;
#pragma unroll
            for (int bj = 0; bj < 2; ++bj) { if (bj < bj_lo || bj >= bj_hi) continue;
                f32x4 v0 = acc[ai][bj][m][0], v1 = acc[ai][bj][m][1];
                if (ACT == 0) { v0 = v0 * sc; v1 = v1 * sc; }
                else {
#pragma unroll
                    for (int e = 0; e < 4; ++e) { const float s0 = sigmoidf_(v0[e]), s1 = sigmoidf_(v1[e]); v0[e] = (ACT == 1) ? v0[e] * s0 : s0; v1[e] = (ACT == 1) ? v1[e] * s1 : s1; } }
                u32x4 w; w.x = cvt_pk_bf16(v0[0], v0[1]); w.y = cvt_pk_bf16(v0[2], v0[3]); w.z = cvt_pk_bf16(v1[0], v1[1]); w.w = cvt_pk_bf16(v1[2], v1[3]);
                *(u32x4*)(rowp + (bj - bj_lo) * HALF) = w; } }
}
__device__ __forceinline__ void epi_f32(const Acc& acc, int bj_lo, int bj_hi, float* dst, int ld, int row0, int col0) {
#pragma unroll
    for (int ai = 0; ai < 2; ++ai)
#pragma unroll
        for (int m = 0; m < 4; ++m) { float* rowp = dst + (size_t)(row0 + ai * HALF + m * 16) * ld + col0;
#pragma unroll
            for (int bj = 0; bj < 2; ++bj) { if (bj < bj_lo || bj >= bj_hi) continue;
                *(f32x4*)(rowp + (bj - bj_lo) * HALF) = acc[ai][bj][m][0]; *(f32x4*)(rowp + (bj - bj_lo) * HALF + 4) = acc[ai][bj][m][1]; } }
}
__device__ __forceinline__ void epi_rope(const Acc& acc, int bj_lo, int bj_hi, bf16_t* dst, int ld, float sc, float* fdst, int fld, bool latent, int row0, int wc, int fq, const float* rope) {
#pragma unroll
    for (int ai = 0; ai < 2; ++ai)
#pragma unroll
        for (int m = 0; m < 4; ++m) { const int row = row0 + ai * HALF + m * 16;
            f32x4 ta = (f32x4){1.f, 0.f, 1.f, 0.f}, tb = ta;
            if (latent) { const int t = (row - MCTX) & 1023, pos = (wc & 1) ? (t & 63) : (t >> 6); const f32x4* rp = (const f32x4*)(rope + (size_t)(pos * 16 + 4 * fq) * 2); ta = rp[0]; tb = rp[1]; }
#pragma unroll
            for (int bj = 0; bj < 2; ++bj) { if (bj < bj_lo || bj >= bj_hi) continue;
                const f32x4 v0 = acc[ai][bj][m][0], v1 = acc[ai][bj][m][1];
                f32x4 o1, o2;
                o1[0] = v0[0] * ta[0] - v0[1] * ta[1]; o2[0] = v0[0] * ta[1] + v0[1] * ta[0];
                o1[1] = v0[2] * ta[2] - v0[3] * ta[3]; o2[1] = v0[2] * ta[3] + v0[3] * ta[2];
                o1[2] = v1[0] * tb[0] - v1[1] * tb[1]; o2[2] = v1[0] * tb[1] + v1[1] * tb[0];
                o1[3] = v1[2] * tb[2] - v1[3] * tb[3]; o2[3] = v1[2] * tb[3] + v1[3] * tb[2];
                const int gcol = (bj - bj_lo) * HALF + wc * 32 + 4 * fq;
                if (fdst) { float* fp = fdst + (size_t)row * fld + gcol; *(f32x4*)fp = o1; *(f32x4*)(fp + 16) = o2; }
                o1 = o1 * sc; o2 = o2 * sc;
                bf16_t* bp = dst + (size_t)row * ld + gcol;
                u32x2 w1, w2; w1.x = cvt_pk_bf16(o1[0], o1[1]); w1.y = cvt_pk_bf16(o1[2], o1[3]); w2.x = cvt_pk_bf16(o2[0], o2[1]); w2.y = cvt_pk_bf16(o2[2], o2[3]);
                *(u32x2*)bp = w1; *(u32x2*)(bp + 16) = w2; } }
}

struct EpiInProj {
    static constexpr bool PERM = true, AFTER_DRAIN = false;
    bf16_t *QA, *KA, *VA, *ZA, *QB, *KB, *VB, *ZB, *GA, *GB; float *OAK, *OAV, *OBK, *OBV; const float* rope;
    __device__ __forceinline__ void operator()(const Acc& acc, const Unit& u, int wr, int wc, int fr, int fq) const {
        const int pn = u.pn, row0 = u.pm * BM + wr * 64 + fr, c8 = wc * 32 + 8 * fq; const bool ctx = u.pm < MCTX / BM;
        if (pn < 2) epi_bf16<0>(acc, 0, 2, QA, 512, row0, pn * 256 + c8, C2);
        else if (pn < 4) { epi_bf16<0>(acc, 0, 2, KA, 512, row0, (pn - 2) * 256 + c8, 1.f); if (ctx) epi_f32(acc, 0, 2, OAK, 512, row0, (pn - 2) * 256 + c8); }
        else if (pn < 6) { epi_bf16<0>(acc, 0, 2, VA, 512, row0, (pn - 4) * 256 + c8, 1.f); if (ctx) epi_f32(acc, 0, 2, OAV, 512, row0, (pn - 4) * 256 + c8); }
        else if (pn < 8) epi_bf16<1>(acc, 0, 2, ZA, 512, row0, (pn - 6) * 256 + c8, 1.f);
        else if (pn < 10) epi_rope(acc, 0, 2, QB + (pn - 8) * 256, 512, C2, nullptr, 0, !ctx, row0, wc, fq, rope);
        else if (pn == 10) { epi_rope(acc, 0, 1, KB, 128, 1.f, ctx ? OBK : nullptr, 128, !ctx, row0, wc, fq, rope);
                             epi_bf16<0>(acc, 1, 2, VB, 128, row0, c8, 1.f); if (ctx) epi_f32(acc, 1, 2, OBV, 128, row0, c8); }
        else if (pn < 13) epi_bf16<1>(acc, 0, 2, ZB, 512, row0, (pn - 11) * 256 + c8, 1.f);
        else if (pn < 17) epi_bf16<2>(acc, 0, 2, GA, 1024, row0, (pn - 13) * 256 + c8, 1.f);
        else epi_bf16<2>(acc, 0, 2, GB, 1024, row0, (pn - 17) * 256 + c8, 1.f);
    }
};
struct EpiMerge {
    static constexpr bool PERM = true, AFTER_DRAIN = false;
    const bf16_t *GA, *GB; float* T; bf16_t* H2;
    __device__ __forceinline__ void operator()(const Acc& acc, const Unit& u, int wr, int wc, int fr, int fq) const {
        const bool second = u.s != 0;
        const char* G = (const char*)(second ? GB : GA); char* Tc = (char*)T; char* Hc = (char*)H2;
        const unsigned e0 = (unsigned)(u.pm * BM + wr * 64 + fr) * DM + (unsigned)(u.pn * BM + wc * 32 + 8 * fq);
        unsigned e0v = e0; asm volatile("" : "+v"(e0v));
#pragma unroll
        for (int ai = 0; ai < 2; ++ai)
#pragma unroll
            for (int m = 0; m < 4; ++m) {
#pragma unroll
                for (int bj = 0; bj < 2; ++bj) { const unsigned e = e0v + (unsigned)((ai * HALF + m * 16) * DM + bj * HALF);
                    const u32x4 g = *(const u32x4*)(G + (size_t)(e * 2u)); const f32x4 v0 = acc[ai][bj][m][0], v1 = acc[ai][bj][m][1];
                    f32x4 r0 = {v0[0] * bf_lo(g.x), v0[1] * bf_hi(g.x), v0[2] * bf_lo(g.y), v0[3] * bf_hi(g.y)}, r1 = {v1[0] * bf_lo(g.z), v1[1] * bf_hi(g.z), v1[2] * bf_lo(g.w), v1[3] * bf_hi(g.w)};
                    float* tp = (float*)(Tc + (size_t)(e * 4u));
                    if (!second) { *(f32x4*)tp = r0; *(f32x4*)(tp + 4) = r1; }
                    else { r0 += *(const f32x4*)tp; r1 += *(const f32x4*)(tp + 4);
                        u32x4 w; w.x = cvt_pk_bf16(r0[0], r0[1]); w.y = cvt_pk_bf16(r0[2], r0[3]); w.z = cvt_pk_bf16(r1[0], r1[1]); w.w = cvt_pk_bf16(r1[2], r1[3]);
                        *(u32x4*)(Hc + (size_t)(e * 2u)) = w; }
                    asm volatile("" ::: "memory"); } }
    }
};
struct EpiOut {
    static constexpr bool PERM = false, AFTER_DRAIN = false;
    const float *xp, *xs, *modf; float* out;
    __device__ __forceinline__ void operator()(const Acc& acc, const Unit& u, int wr, int wc, int fr, int fq) const {
        const bool ctx = u.pm < MCTX / BM; const int vi = ctx ? 8 : ((u.pm - MCTX / BM) >> 2);
        const float* xb = ctx ? xp : xs - (size_t)MCTX * DM; const float* gp = modf + (size_t)vi * 3072 + 2048;
        const int row0 = u.pm * BM + wr * 64 + fr, col0 = u.pn * BM + wc * 32 + 4 * fq;
#pragma unroll
        for (int bj = 0; bj < 2; ++bj)
#pragma unroll
            for (int n = 0; n < 2; ++n) { const f32x4 gv = *(const f32x4*)(gp + col0 + bj * HALF + n * 16);
#pragma unroll
                for (int ai = 0; ai < 2; ++ai)
#pragma unroll
                    for (int m = 0; m < 4; ++m) { const size_t off = (size_t)(row0 + ai * HALF + m * 16) * DM + col0 + bj * HALF + n * 16;
                        const f32x4 xv = *(const f32x4*)(xb + off); *(f32x4*)(out + off) = xv + gv * acc[ai][bj][m][n]; } }
    }
};

template <class Epi, class Sched, bool ALIGN_EPI>
__device__ __forceinline__ void gemm_phase(PG8_LAS unsigned char* lds, const GemmCfg g, const Sched& S, const Epi& E) {
    const int tid = threadIdx.x, wid = __builtin_amdgcn_readfirstlane(tid >> 6), lane = tid & 63, wr = wid >> 2, wc = wid & 3, fr = lane & 15, fq = lane >> 4;
    const int nt = g.K / BK;
    unsigned voffA[2], voffB[2];
#pragma unroll
    for (int i = 0; i < 2; ++i) { int R, C; stage_rc(tid * 16 + i * 8192, R, C); const int Rb = Epi::PERM ? ((R & ~31) + perm32(R & 31)) : R;
        voffA[i] = (unsigned)(R * g.lda + C * 2); voffB[i] = (unsigned)(Rb * g.ldb + C * 2); }
    const size_t kstep = (size_t)(BK * 2);
    const size_t hstepA = (size_t)HALF * g.lda, hstepB = (size_t)HALF * g.ldb;
    const unsigned ldsw = (unsigned)wid * 1024u;
    const int aoff = lds_byte(wr * 64 + fr, fq * 8), boff = lds_byte(wc * 32 + fr, fq * 8);
#define PG8_SA(b, h) (((b) * 2 + (h)) * HTB)
#define PG8_SB(b, h) ((4 + (b) * 2 + (h)) * HTB)
#define PG8_STAGE(bufoff, gbase, voff) do { _Pragma("unroll") for (int _i = 0; _i < 2; ++_i) \
        __builtin_amdgcn_global_load_lds((const unsigned*)((const char*)(gbase) + (voff)[_i]), (PG8_LAS unsigned*)(lds + (bufoff) + ldsw + _i * 8192), 16, 0, 0); } while (0)
#define PG8_LDA(dst, b, h) do { _Pragma("unroll") for (int m = 0; m < 4; ++m) _Pragma("unroll") for (int k = 0; k < 2; ++k) dst[m][k] = *(const PG8_LAS bf16x8*)(lds + PG8_SA(b, h) + aoff + m * 2048 + k * 1024); } while (0)
#define PG8_LDB(dst, b, h) do { _Pragma("unroll") for (int n = 0; n < 2; ++n) _Pragma("unroll") for (int k = 0; k < 2; ++k) dst[n][k] = *(const PG8_LAS bf16x8*)(lds + PG8_SB(b, h) + boff + n * 2048 + k * 1024); } while (0)
#define PG8_MMA(ai, bj, At, Bt) do { __builtin_amdgcn_s_setprio(1); _Pragma("unroll") for (int m = 0; m < 4; ++m) _Pragma("unroll") for (int n = 0; n < 2; ++n) _Pragma("unroll") for (int k = 0; k < 2; ++k) \
        acc[ai][bj][m][n] = __builtin_amdgcn_mfma_f32_16x16x32_bf16(Bt[n][k], At[m][k], acc[ai][bj][m][n], 0, 0, 0); __builtin_amdgcn_s_setprio(0); } while (0)
#define PG8_WAIT_V(n) asm volatile("s_waitcnt vmcnt(" #n ")" ::: "memory")
#define PG8_WAIT_L(n) asm volatile("s_waitcnt lgkmcnt(" #n ")" ::: "memory")
#define PG8_BAR __builtin_amdgcn_s_barrier()
#define PG8_SCHED __builtin_amdgcn_sched_barrier(0)
    Unit cur, nxt; int ui = 0;
    if (!S.next(0, cur)) return;
    Acc acc;
#pragma unroll
    for (int a = 0; a < 2; ++a)
#pragma unroll
        for (int b = 0; b < 2; ++b)
#pragma unroll
            for (int m = 0; m < 4; ++m)
#pragma unroll
                for (int n = 0; n < 2; ++n) acc[a][b][m][n] = (f32x4){0.f, 0.f, 0.f, 0.f};
    bf16x8 At[4][2], B0[2][2], B1[2][2];
    const char* cA = cur.Ab; const char* cB = cur.Bb;
    PG8_STAGE(PG8_SB(0, 0), cB, voffB); PG8_STAGE(PG8_SB(0, 1), cB + hstepB, voffB); PG8_STAGE(PG8_SA(0, 0), cA, voffA); PG8_STAGE(PG8_SA(0, 1), cA + hstepA, voffA);
    if (wr == 1) PG8_BAR;
    PG8_WAIT_V(2); PG8_BAR;
    PG8_STAGE(PG8_SB(1, 0), cB + kstep, voffB); PG8_STAGE(PG8_SA(1, 0), cA + kstep, voffA); PG8_STAGE(PG8_SB(1, 1), cB + hstepB + kstep, voffB);
    PG8_WAIT_V(6); PG8_BAR;
    for (;;) {
        const bool has_next = S.next(ui + 1, nxt);
        const char* nA = has_next ? nxt.Ab : cA; const char* nB = has_next ? nxt.Bb : cB;
        for (int t = 0; t < nt; t += 2) {
            const bool last = (t == nt - 2);
            const char* a1 = cA + (size_t)(t + 1) * kstep;
            const char* a2 = last ? nA : cA + (size_t)(t + 2) * kstep; const char* b2 = last ? nB : cB + (size_t)(t + 2) * kstep;
            const char* a3 = a2 + kstep; const char* b3 = b2 + kstep;
            PG8_LDB(B0, 0, 0); PG8_LDB(B1, 0, 1); PG8_SCHED; PG8_LDA(At, 0, 0); PG8_STAGE(PG8_SA(1, 1), a1 + hstepA, voffA);
            PG8_WAIT_V(8); PG8_WAIT_L(0); PG8_BAR; PG8_MMA(0, 0, At, B0); PG8_MMA(0, 1, At, B1); PG8_BAR; PG8_SCHED;
            PG8_LDA(At, 0, 1); PG8_STAGE(PG8_SB(0, 0), b2, voffB); PG8_STAGE(PG8_SB(0, 1), b2 + hstepB, voffB); PG8_STAGE(PG8_SA(0, 0), a2, voffA);
            PG8_WAIT_V(8); PG8_WAIT_L(0); PG8_BAR; PG8_MMA(1, 0, At, B0); PG8_MMA(1, 1, At, B1); PG8_BAR; PG8_SCHED;
            PG8_LDB(B0, 1, 0); PG8_LDB(B1, 1, 1); PG8_SCHED; PG8_LDA(At, 1, 0); PG8_STAGE(PG8_SA(0, 1), a2 + hstepA, voffA);
            PG8_WAIT_V(8); PG8_WAIT_L(0); PG8_BAR; PG8_MMA(0, 0, At, B0); PG8_MMA(0, 1, At, B1); PG8_BAR; PG8_SCHED;
            PG8_LDA(At, 1, 1); PG8_STAGE(PG8_SB(1, 0), b3, voffB); PG8_STAGE(PG8_SB(1, 1), b3 + hstepB, voffB); PG8_STAGE(PG8_SA(1, 0), a3, voffA);
            PG8_WAIT_V(8); PG8_WAIT_L(0); PG8_BAR; PG8_MMA(1, 0, At, B0); PG8_MMA(1, 1, At, B1); PG8_BAR; PG8_SCHED;
        }
        if constexpr (ALIGN_EPI) { if (wr == 0) PG8_BAR; }
        E(acc, cur, wr, wc, fr, fq);
        if (!has_next) break;
#pragma unroll
        for (int a = 0; a < 2; ++a)
#pragma unroll
            for (int b = 0; b < 2; ++b)
#pragma unroll
                for (int m = 0; m < 4; ++m)
#pragma unroll
                    for (int n = 0; n < 2; ++n) acc[a][b][m][n] = (f32x4){0.f, 0.f, 0.f, 0.f};
        cur = nxt; cA = nA; cB = nB; ++ui;
        if constexpr (ALIGN_EPI) { if (wr == 1) PG8_BAR; }
    }
    PG8_WAIT_V(0);
    if constexpr (!ALIGN_EPI) { if (wr == 0) PG8_BAR; }
    PG8_BAR;
#undef PG8_SA
#undef PG8_SB
#undef PG8_STAGE
#undef PG8_LDA
#undef PG8_LDB
#undef PG8_MMA
#undef PG8_WAIT_V
#undef PG8_WAIT_L
#undef PG8_BAR
#undef PG8_SCHED
}
}

namespace att {
using bf16 = unsigned short;
using bf16x8 = __attribute__((ext_vector_type(8))) short;
using s16x4 = __attribute__((ext_vector_type(4))) short;
using f32x16 = __attribute__((ext_vector_type(16))) float;
using u32x4 = __attribute__((ext_vector_type(4))) unsigned;
typedef short v4i16_t __attribute__((ext_vector_type(4)));
#define ALAS __attribute__((address_space(3)))
typedef ALAS const char* lds_cptr;
constexpr int NSLOT = 3, SLOTB = 8192;
constexpr int LDS_K = 0, LDS_V = NSLOT * SLOTB, LDS_WS = 2 * NSLOT * SLOTB, LDS_OST = LDS_WS + 8 * 256, LDS_BT = LDS_OST + 8 * 4096, LDS_END = LDS_BT + 15 * 128 * 4;
constexpr float THR = 8.0f;

__device__ __forceinline__ int crow(int r, int hi) { return (r & 3) + 8 * (r >> 2) + 4 * hi; }
__device__ __forceinline__ void glds16(const void* gsrc, unsigned lds_dst) { unsigned keep;
    asm volatile("s_mov_b32 %0, m0\n\ts_mov_b32 m0, %2\n\ts_nop 0\n\tglobal_load_lds_dwordx4 %1, off\n\ts_mov_b32 m0, %0" : "=&s"(keep) : "v"(gsrc), "s"(lds_dst) : "memory"); }
__device__ __forceinline__ unsigned cvtpk(float lo, float hi) { typedef float f2 __attribute__((ext_vector_type(2))); typedef __bf16 b2 __attribute__((ext_vector_type(2))); f2 v = {lo, hi}; b2 b = __builtin_convertvector(v, b2); return __builtin_bit_cast(unsigned, b); }
__device__ __forceinline__ s16x4 vtr(lds_cptr p) { return __builtin_bit_cast(s16x4, __builtin_amdgcn_ds_read_tr16_b64_v4i16((ALAS v4i16_t*)p)); }
#define ATT_WAIT_BAR(N) asm volatile("s_waitcnt vmcnt(" #N ") lgkmcnt(0)\n\ts_barrier" ::: "memory")

struct AttnP { bf16 *QA, *ZA, *QB, *ZB; const bf16 *KA, *VA, *KB, *VB, *CAK, *CAV, *CBK, *CBV; const float *rpb, *sink; };

__device__ __forceinline__ void attn_unit(const AttnP& P, int kind, int b, int h, int x, ALAS unsigned char* shm) {
    const int tid = threadIdx.x, lane = tid & 63, r32 = lane & 31, hi = lane >> 5; const int wid = __builtin_amdgcn_readfirstlane(tid >> 6);
    const bf16 *locK, *locV, *ctxK, *ctxV; int ldk, loc_row0, ctx_row0 = 0, NTloc, NTctx = 0;
    bf16* Qw; const bf16* Zw; float m_run = -1e30f, l_run = 0.f;
    int a_lo = 0, a_hi = 1 << 30;
    int dr0 = 0, qc = 0;
    int e_lo = -1, e_hi = -1, qq = 0;
    if (kind == 0) {
        locK = P.KA + h * 64; locV = P.VA + h * 64; ldk = 512; loc_row0 = b * 256; NTloc = 4; ctxK = locK; ctxV = locV;
        const size_t qo = (size_t)(b * 256 + wid * 32) * 512 + h * 64; Qw = P.QA + qo; Zw = P.ZA + qo;
    } else if (kind == 1) {
        locK = P.KB + h * 64; locV = P.VB + h * 64; ldk = 128; loc_row0 = b * 256; NTloc = 4; ctxK = locK; ctxV = locV;
        const int qh = 4 * h + (wid >> 1); const size_t qo = (size_t)(b * 256 + x * 64 + (wid & 1) * 32) * 512 + qh * 64; Qw = P.QB + qo; Zw = P.ZB + qo;
        m_run = P.sink[qh] * LOG2E; l_run = hi ? 0.f : 1.f;
    } else if (kind == 2) {
        const int kr0 = (x == 0 || x == 1) ? 0 : (x == 2 ? 4 : 8); NTloc = (x == 0 || x == 3) ? 8 : 11;
        locK = P.KA + h * 64; locV = P.VA + h * 64; ldk = 512; loc_row0 = MCTX + b * 1024 + kr0 * 64;
        ctxK = P.CAK + h * 64; ctxV = P.CAV + h * 64; ctx_row0 = b * 512; NTctx = 8;
        const int r = 4 * x + (wid >> 1), ch = wid & 1; int rs = r - 4; rs = rs < 0 ? 0 : (rs > 8 ? 8 : rs);
        a_lo = rs - kr0; a_hi = a_lo + 8; dr0 = kr0 - r; qc = 32 * ch + r32;
        const size_t qo = (size_t)(MCTX + b * 1024 + r * 64 + ch * 32) * 512 + h * 64; Qw = P.QA + qo; Zw = P.ZA + qo;
    } else {
        const int tl0 = x - 2 < 0 ? 0 : x - 2, tl1 = x + 2 > 15 ? 15 : x + 2; NTloc = tl1 - tl0 + 1;
        locK = P.KB + h * 64; locV = P.VB + h * 64; ldk = 128; loc_row0 = MCTX + b * 1024 + tl0 * 64;
        ctxK = P.CBK + h * 64; ctxV = P.CBV + h * 64; ctx_row0 = b * 512; NTctx = 8;
        e_lo = (x - 2 >= 0) ? 0 : -1; e_hi = (x + 2 <= 15) ? (x + 2 - tl0) : -1; qq = (wid & 1) * 32 + r32;
        const int qh = 4 * h + (wid >> 1); const size_t qo = (size_t)(MCTX + b * 1024 + x * 64 + (wid & 1) * 32) * 512 + qh * 64; Qw = P.QB + qo; Zw = P.ZB + qo;
        m_run = P.sink[qh] * LOG2E; l_run = hi ? 0.f : 1.f;
    }
    const int NT = NTloc + NTctx;
    const unsigned lds0 = (unsigned)(uintptr_t)shm;
    ALAS float* wsf = (ALAS float*)(shm + LDS_WS) + wid * 64;
    ALAS float* BT = (ALAS float*)(shm + LDS_BT);
    f32x16 M0 = f32x16{}, M1 = f32x16{}; int bt_l = 0;
    if (kind == 2) {
        for (int i = tid; i < 15 * 128; i += 512) { const int j = i >> 7, dc = (i & 127) - 63; BT[i] = (dc >= -15 && dc <= 15) ? P.rpb[h * 465 + j * 31 + dc + 15] * LOG2E : 0.f; }
        int ws_ = qc - 8; ws_ = ws_ < 0 ? 0 : (ws_ > 48 ? 48 : ws_);
#pragma unroll
        for (int r = 0; r < 16; ++r) { const int kc = crow(r, hi); M0[r] = ((unsigned)(kc - ws_) < 16u) ? 0.f : -INFINITY; M1[r] = ((unsigned)(kc + 32 - ws_) < 16u) ? 0.f : -INFINITY; }
        bt_l = (dr0 + 7) * 128 + 4 * hi - qc + 63;
    }
    const int kl_off = lane * ldk + wid * 8, vl_off = (16 * (wid & 3) + (lane >> 2)) * ldk + (wid >> 2) * 32 + (lane & 3) * 8;
#define ATT_ISSUE(t) do { const int t_ = (t); const int sl_ = (t_ % NSLOT) * SLOTB; \
        const size_t ro_ = (t_ < NTloc) ? (size_t)(loc_row0 + 64 * t_) * ldk : (size_t)(ctx_row0 + 64 * (t_ - NTloc)) * ldk; \
        const bf16* kt_ = ((t_ < NTloc) ? locK : ctxK) + ro_; const bf16* vt_ = ((t_ < NTloc) ? locV : ctxV) + ro_; \
        glds16(kt_ + kl_off, (unsigned)__builtin_amdgcn_readfirstlane(lds0 + LDS_K + sl_ + wid * 1024)); \
        glds16(vt_ + vl_off, (unsigned)__builtin_amdgcn_readfirstlane(lds0 + LDS_V + sl_ + wid * 1024)); } while (0)
    bf16x8 qr[4];
#pragma unroll
    for (int d0 = 0; d0 < 4; ++d0) qr[d0] = *reinterpret_cast<const bf16x8*>(&Qw[(size_t)r32 * 512 + d0 * 16 + hi * 8]);
    ATT_ISSUE(0); ATT_ISSUE(1);
    f32x16 o[2]; o[0] = f32x16{}; o[1] = f32x16{};
    const lds_cptr kp0 = (lds_cptr)(shm + LDS_K) + hi * 1024 + r32 * 16;
    const lds_cptr vp0 = (lds_cptr)(shm + LDS_V) + ((lane >> 4) & 1) * 32 + (lane & 3) * 8 + (4 * hi + ((lane & 15) >> 2)) * 64;
    for (int t = 0; t < NT; ++t) {
        if (t + 1 < NT) ATT_WAIT_BAR(2); else ATT_WAIT_BAR(0);
        if (t + 2 < NT) ATT_ISSUE(t + 2);
        const bool local = t < NTloc;
        if (local && (t < a_lo || t >= a_hi)) continue;
        const int sl = (t % NSLOT) * SLOTB;
        f32x16 p0, p1;
        if (kind == 2 && local) {
            const ALAS float* bt = BT + bt_l + t * 128;
#pragma unroll
            for (int r = 0; r < 16; ++r) { const int cr = (r & 3) + 8 * (r >> 2); p0[r] = M0[r] + bt[cr]; p1[r] = M1[r] + bt[cr + 32]; }
        } else { p0 = f32x16{}; p1 = f32x16{}; }
        { const lds_cptr kb = kp0 + sl;
#pragma unroll
          for (int d0 = 0; d0 < 4; ++d0) { const bf16x8 k0 = *(const ALAS bf16x8*)(kb + d0 * 2048), k1 = *(const ALAS bf16x8*)(kb + d0 * 2048 + 512);
              p0 = __builtin_amdgcn_mfma_f32_32x32x16_bf16(k0, qr[d0], p0, 0, 0, 0); p1 = __builtin_amdgcn_mfma_f32_32x32x16_bf16(k1, qr[d0], p1, 0, 0, 0); } }
        if (kind == 3 && (t == e_lo || t == e_hi)) {
            int qv = qq - 4 * hi; asm volatile("" : "+v"(qv));
            if (t == e_lo) {
#pragma unroll
                for (int r = 0; r < 16; ++r) { const int kk = (r & 3) + 8 * (r >> 2); if (kk < qv) p0[r] = -INFINITY; if (kk + 32 < qv) p1[r] = -INFINITY; }
            } else {
#pragma unroll
                for (int r = 0; r < 16; ++r) { const int kk = (r & 3) + 8 * (r >> 2); if (kk > qv) p0[r] = -INFINITY; if (kk + 32 > qv) p1[r] = -INFINITY; }
            }
        }
        float rm;
        { float a = fmaxf(fmaxf(p0[0], p0[1]), p1[0]), c = fmaxf(fmaxf(p0[2], p0[3]), p1[1]); a = fmaxf(fmaxf(a, p1[2]), p1[3]);
#pragma unroll
          for (int r = 4; r < 16; r += 4) { a = fmaxf(fmaxf(a, p0[r]), p0[r + 1]); c = fmaxf(fmaxf(c, p0[r + 2]), p0[r + 3]); a = fmaxf(fmaxf(a, p1[r]), p1[r + 1]); c = fmaxf(fmaxf(c, p1[r + 2]), p1[r + 3]); }
          rm = fmaxf(a, c); auto rr = __builtin_amdgcn_permlane32_swap(__float_as_uint(rm), __float_as_uint(rm), false, false); rm = fmaxf(__uint_as_float(rr[0]), __uint_as_float(rr[1])); }
        if (__any(rm > m_run + THR)) {
            const float mn = fmaxf(m_run, rm), al = __builtin_amdgcn_exp2f(m_run - mn); l_run *= al; m_run = mn;
            if (hi == 0) wsf[r32] = al;
            asm volatile("s_waitcnt lgkmcnt(0)" ::: "memory");
#pragma unroll
            for (int r = 0; r < 16; ++r) { const float f = wsf[crow(r, hi)]; o[0][r] *= f; o[1][r] *= f; }
            asm volatile("" ::: "memory");
        }
        float sacc = 0.f;
#pragma unroll
        for (int r = 0; r < 16; ++r) { p0[r] = __builtin_amdgcn_exp2f(p0[r] - m_run); p1[r] = __builtin_amdgcn_exp2f(p1[r] - m_run); sacc += p0[r] + p1[r]; }
        l_run += sacc;
        u32x4 pw[4];
        pw[0] = (u32x4){cvtpk(p0[0], p0[1]), cvtpk(p0[2], p0[3]), cvtpk(p0[4], p0[5]), cvtpk(p0[6], p0[7])};
        pw[1] = (u32x4){cvtpk(p0[8], p0[9]), cvtpk(p0[10], p0[11]), cvtpk(p0[12], p0[13]), cvtpk(p0[14], p0[15])};
        pw[2] = (u32x4){cvtpk(p1[0], p1[1]), cvtpk(p1[2], p1[3]), cvtpk(p1[4], p1[5]), cvtpk(p1[6], p1[7])};
        pw[3] = (u32x4){cvtpk(p1[8], p1[9]), cvtpk(p1[10], p1[11]), cvtpk(p1[12], p1[13]), cvtpk(p1[14], p1[15])};
        { const lds_cptr vp = vp0 + sl;
#pragma unroll
          for (int d0 = 0; d0 < 2; ++d0)
#pragma unroll
              for (int ks = 0; ks < 4; ++ks) { const s16x4 lo = vtr(vp + d0 * 4096 + ks * 1024), hh = vtr(vp + d0 * 4096 + ks * 1024 + 512);
                  const bf16x8 vf = (bf16x8){lo[0], lo[1], lo[2], lo[3], hh[0], hh[1], hh[2], hh[3]};
                  o[d0] = __builtin_amdgcn_mfma_f32_32x32x16_bf16(__builtin_bit_cast(bf16x8, pw[ks]), vf, o[d0], 0, 0, 0); } }
    }
    { auto rr = __builtin_amdgcn_permlane32_swap(__float_as_uint(l_run), __float_as_uint(l_run), false, false); l_run = __uint_as_float(rr[0]) + __uint_as_float(rr[1]); }
    if (hi == 0) wsf[32 + r32] = l_run;
    asm volatile("s_waitcnt lgkmcnt(0)" ::: "memory");
    float rli[16];
#pragma unroll
    for (int r = 0; r < 16; ++r) rli[r] = __builtin_amdgcn_rcpf(wsf[32 + crow(r, hi)]);
    { ALAS bf16* stg = (ALAS bf16*)(shm + LDS_OST) + wid * 2048;
#pragma unroll
      for (int r = 0; r < 16; ++r) { const int orow = crow(r, hi);
#pragma unroll
          for (int d0 = 0; d0 < 2; ++d0) { const unsigned w = cvtpk(o[d0][r] * rli[r], 0.f); stg[orow * 64 + d0 * 32 + r32] = (bf16)(w & 0xffffu); } }
      asm volatile("s_waitcnt lgkmcnt(0)" ::: "memory");
#pragma unroll
      for (int i = 0; i < 4; ++i) { const int row = i * 8 + (lane >> 3), ch = lane & 7; const u32x4 v = *(const ALAS u32x4*)(stg + row * 64 + ch * 8);
          const u32x4 z = *(const u32x4*)(Zw + (size_t)row * 512 + ch * 8); u32x4 w;
          w.x = cvtpk(pg8::bf_lo(v.x) * pg8::bf_lo(z.x), pg8::bf_hi(v.x) * pg8::bf_hi(z.x)); w.y = cvtpk(pg8::bf_lo(v.y) * pg8::bf_lo(z.y), pg8::bf_hi(v.y) * pg8::bf_hi(z.y));
          w.z = cvtpk(pg8::bf_lo(v.z) * pg8::bf_lo(z.z), pg8::bf_hi(v.z) * pg8::bf_hi(z.z)); w.w = cvtpk(pg8::bf_lo(v.w) * pg8::bf_lo(z.w), pg8::bf_hi(v.w) * pg8::bf_hi(z.w));
          *(u32x4*)(Qw + (size_t)row * 512 + ch * 8) = w; } }
    asm volatile("s_waitcnt vmcnt(0) lgkmcnt(0)\n\ts_barrier" ::: "memory");
#undef ATT_ISSUE
}
}

constexpr int NWAVES = 8;
constexpr int N_LAUNCHES = MK_N_LAUNCHES;
constexpr int PER_PHASE = 7;
constexpr size_t MiB = 1u << 20;
constexpr size_t WS_CTL = 0, CTL_ZERO_BYTES = 1 * MiB;
constexpr size_t WS_MODP = 1 * MiB;
constexpr size_t WS_MODF = 3 * MiB;
constexpr size_t WS_ROPE = 3 * MiB + 512 * 1024;
constexpr size_t WS_WIN = 4 * MiB;
constexpr size_t WS_WBA = 15 * MiB, WS_WBB = 16 * MiB, WS_WOUT = 17 * MiB;
constexpr size_t WS_CAK = 19 * MiB, WS_CAV = 23 * MiB, WS_CBK = 27 * MiB, WS_CBV = 28 * MiB;
constexpr size_t WS_H = 32 * MiB;
constexpr size_t WS_QA = 64 * MiB, WS_KA = 80 * MiB, WS_VA = 96 * MiB, WS_ZA = 112 * MiB, WS_QB = 128 * MiB, WS_KB = 144 * MiB, WS_VB = 148 * MiB, WS_ZB = 152 * MiB;
constexpr size_t WS_GA = 168 * MiB, WS_GB = 200 * MiB, WS_END = 232 * MiB;
constexpr size_t WS_T = WS_KA;
constexpr int CW_BAR = 4096;
constexpr int RING_OFF = 0, RING_BYTES = 131072, LDSCTL_OFF = RING_BYTES, MISC_OFF = LDSCTL_OFF + 320, LDS_BYTES = 147456;
static_assert(att::LDS_END <= RING_BYTES, "attention scratch inside the ring region");

#define GAS __attribute__((address_space(1)))
#define LAS __attribute__((address_space(3)))
typedef unsigned short bf16;
typedef unsigned v4u __attribute__((ext_vector_type(4)));
typedef float f32x4 __attribute__((ext_vector_type(4)));
typedef GAS unsigned gu32;
#define RLX_AGENT __ATOMIC_RELAXED, __HIP_MEMORY_SCOPE_AGENT
#define LDS_WAIT() asm volatile("s_waitcnt lgkmcnt(0)" ::: "memory")
__device__ __forceinline__ unsigned f2bf(float f) { unsigned u = __builtin_bit_cast(unsigned, f); return (u + 0x7fffu + ((u >> 16) & 1u)) >> 16; }
__device__ __forceinline__ unsigned pk2(float lo, float hi) { return f2bf(lo) | (f2bf(hi) << 16); }

#define XB_TMO      128
#define XB_XCNT(j)  (256  + 64 * (j))
#define XB_XSUB(j)  (1280 + 64 * (j))
#define XB_XGEN(j)  (2304 + 64 * (j))
#define XB_TOP      3328
#define XB_TOPGEN   3392
#define XCD_BAR_WORDS 3456
#define XB_SPIN_CAP (1u << 18)
__device__ __forceinline__ unsigned xb_ld(unsigned* p)              { return __hip_atomic_load(p, __ATOMIC_RELAXED, __HIP_MEMORY_SCOPE_AGENT); }
__device__ __forceinline__ unsigned xb_add(unsigned* p, unsigned v) { return __hip_atomic_fetch_add(p, v, __ATOMIC_RELAXED, __HIP_MEMORY_SCOPE_AGENT); }
__device__ __forceinline__ unsigned xb_xcc_id() { return (unsigned)__builtin_amdgcn_s_getreg((3 << 11) | 20) & 0xFu; }
#define XB_SPIN(cond, bar) do { unsigned _sp = 0; while (cond) { __builtin_amdgcn_s_sleep(1); \
    if ((++_sp & 255u) == 0u) { if (xb_ld(&(bar)[XB_TMO])) break; if (_sp > XB_SPIN_CAP) { atomicAdd(&(bar)[XB_TMO], 1u); break; } } } } while (0)
struct XcdBarrier { unsigned* bar; unsigned x; volatile LAS unsigned* st; };
__device__ __forceinline__ XcdBarrier xcd_barrier_post(unsigned* bar, volatile LAS unsigned* st) {
    XcdBarrier b; b.bar = bar; b.x = xb_xcc_id(); b.st = st;
    if (threadIdx.x == 0) (void)xb_add(&bar[XB_XCNT(b.x)], 1u);
    return b;
}
__device__ __forceinline__ void xcd_barrier_complete(unsigned* bar, unsigned x, unsigned& nloc, unsigned& nx) {
    const unsigned G = gridDim.x * gridDim.y * gridDim.z;
    unsigned sum, cnt, mine, sp = 0u;
    for (;;) {
        sum = 0u; cnt = 0u; mine = 0u;
#pragma unroll
        for (unsigned j = 0; j < 16; ++j) { const unsigned c = xb_ld(&bar[XB_XCNT(j)]); sum += c; cnt += (c > 0u) ? 1u : 0u; mine = (j == x) ? c : mine; }
        if (sum == G) break;
        __builtin_amdgcn_s_sleep(1);
        if ((++sp & 255u) == 0u) { if (xb_ld(&bar[XB_TMO])) break; if (sp > XB_SPIN_CAP) { atomicAdd(&bar[XB_TMO], 1u); break; } }
    }
    nloc = mine > 0u ? mine : 1u; nx = cnt > 0u ? cnt : 1u;
}
__device__ __forceinline__ void xcd_barrier(const XcdBarrier& b) {
    asm volatile("s_waitcnt vmcnt(0)" ::: "memory");
    __syncthreads();
    if (threadIdx.x == 0) {
        unsigned* bar = b.bar;
        __builtin_amdgcn_s_waitcnt(0);
        unsigned nloc = b.st[0], nx = b.st[1];
        if (nloc == 0u) { xcd_barrier_complete(bar, b.x, nloc, nx); b.st[0] = nloc; b.st[1] = nx; }
        const unsigned old = xb_add(&bar[XB_XSUB(b.x)], 1u);
        const unsigned gen = old / nloc;
        if (old + 1u == (gen + 1u) * nloc) {
            __builtin_amdgcn_fence(__ATOMIC_RELEASE, "agent");
            asm volatile("s_waitcnt vmcnt(0)" ::: "memory");
            const unsigned og = xb_add(&bar[XB_TOP], 1u);
            const unsigned tg = og / nx;
            if (og + 1u == (tg + 1u) * nx) xb_add(&bar[XB_TOPGEN], 1u);
            else XB_SPIN(xb_ld(&bar[XB_TOPGEN]) == tg, bar);
            __builtin_amdgcn_fence(__ATOMIC_ACQUIRE, "agent");
            xb_add(&bar[XB_XGEN(b.x)], 1u);
            asm volatile("s_waitcnt vmcnt(0)" ::: "memory");
        } else {
            XB_SPIN(xb_ld(&bar[XB_XGEN(b.x)]) == gen, bar);
            __builtin_amdgcn_fence(__ATOMIC_ACQUIRE, "agent");
            asm volatile("s_waitcnt vmcnt(0)" ::: "memory");
        }
    }
    __syncthreads();
}

struct Args { const float* in[17]; float* out; unsigned char* ws; int ph_lo, ph_hi, li, pad; };

__device__ __forceinline__ float wave_sum(float v) {
#pragma unroll
    for (int o = 1; o < 64; o <<= 1) v += __shfl_xor(v, o);
    return v;
}
__device__ __forceinline__ int rope_pos(int n) { const int d = n & 31, s = d >> 4, dd = d & 15; return (n & ~31) + 8 * (dd >> 2) + 2 * (dd & 3) + s; }
__device__ __forceinline__ void transpose_item(const float* W, int K, int N, bf16* WT, LAS float* scr, int item, int lane, bool win) {
    const int nblk = N / 32, kb = item / nblk, nb = item % nblk, k0 = 64 * kb, n0 = 32 * nb;
#pragma unroll 8
    for (int i = 0; i < 32; ++i) { const int kk = 2 * i + (lane >> 5); scr[kk * 33 + (lane & 31)] = W[(size_t)(k0 + kk) * N + n0 + (lane & 31)]; }
    LDS_WAIT(); asm volatile("" ::: "memory");
    const int c = lane & 7;
    const bool rp = win && ((n0 >= 2048 && n0 < 2560 + 128));
#pragma unroll
    for (int j = 0; j < 4; ++j) { const int n = (lane >> 3) + 8 * j; const LAS float* s = scr + (8 * c) * 33 + n;
        v4u o; o.x = pk2(s[0 * 33], s[1 * 33]); o.y = pk2(s[2 * 33], s[3 * 33]); o.z = pk2(s[4 * 33], s[5 * 33]); o.w = pk2(s[6 * 33], s[7 * 33]);
        const int drow = rp ? rope_pos(n0 + n) : (n0 + n);
        *(GAS v4u*)(WT + (size_t)drow * K + k0 + 8 * c) = o; }
    LDS_WAIT(); asm volatile("" ::: "memory");
}

struct SchedInProj { int c, G; const char* A; const char* B;
    __device__ __forceinline__ bool next(int i, pg8::Unit& u) const { const int L = i * G + c; if (L >= 64 * 21) return false; pg8::tile_of(L, 64, 21, u.pm, u.pn); u.s = 0;
        u.Ab = A + (size_t)u.pm * 256 * 2048; u.Bb = B + (size_t)u.pn * 256 * 2048; return true; } };
struct SchedMerge { int c; const char *UA, *UB, *WA, *WB;
    __device__ __forceinline__ bool next(int i, pg8::Unit& u) const { if (i >= 2) return false; pg8::tile_of(c, 64, 4, u.pm, u.pn); u.s = i;
        u.Ab = (i ? UB : UA) + (size_t)u.pm * 256 * 1024; u.Bb = (i ? WB : WA) + (size_t)u.pn * 256 * 1024; return true; } };
struct SchedOut { int c; const char *A, *B;
    __device__ __forceinline__ bool next(int i, pg8::Unit& u) const { if (i >= 1) return false; pg8::tile_of(c, 64, 4, u.pm, u.pn); u.s = 0;
        u.Ab = A + (size_t)u.pm * 256 * 2048; u.Bb = B + (size_t)u.pn * 256 * 2048; return true; } };

template <int PH_LO, int PH_HI>
__global__ void __launch_bounds__(NWAVES * 64, 2) fwd_kernel(Args args) {
    extern __shared__ __attribute__((aligned(16))) unsigned char lds_raw[];
    LAS unsigned char* lds = (LAS unsigned char*)lds_raw;
    volatile LAS unsigned* MISC = (volatile LAS unsigned*)(lds + MISC_OFF);
    const int tid = threadIdx.x, lane = tid & 63, wave = __builtin_amdgcn_readfirstlane(tid >> 6);
    const int G = gridDim.x, bx = blockIdx.x, vcu = (G % 8 == 0) ? (bx % 8) * (G / 8) + bx / 8 : bx;
    unsigned char* ws = args.ws;
    gu32* ctl = (gu32*)(ws + WS_CTL);
    for (int u = tid; u < (LDS_BYTES - LDSCTL_OFF) / 4; u += NWAVES * 64) ((LAS unsigned*)(lds + LDSCTL_OFF))[u] = 0u;
    if (tid == 0) { __builtin_amdgcn_fence(__ATOMIC_ACQUIRE, "agent"); asm volatile("s_waitcnt vmcnt(0)" ::: "memory"); }
    __syncthreads();
    XcdBarrier bar; bar.bar = (unsigned*)(ctl + CW_BAR); bar.x = 0; bar.st = nullptr;
    if (N_LAUNCHES != PER_PHASE) bar = xcd_barrier_post((unsigned*)(ctl + CW_BAR), MISC + 8);
#define GRID_BAR() do { if (N_LAUNCHES != PER_PHASE) xcd_barrier(bar); } while (0)
#define IN(k) (PH_LO <= (k) && (k) < PH_HI)
#define BOTH(k) (IN(k) && IN((k) + 1))
    const float* x_prompt = args.in[0]; const float* x_sample = args.in[1];
    float* const MODP = (float*)(ws + WS_MODP); float* const MODF = (float*)(ws + WS_MODF); float* const ROPE = (float*)(ws + WS_ROPE);
    bf16* const WIN = (bf16*)(ws + WS_WIN); bf16* const WBA = (bf16*)(ws + WS_WBA); bf16* const WBB = (bf16*)(ws + WS_WBB); bf16* const WOUT = (bf16*)(ws + WS_WOUT);
    bf16* const HB = (bf16*)(ws + WS_H);
    const int gw = vcu * NWAVES + wave, NGW = G * NWAVES;

    if (IN(0)) {
        LAS float* scr = (LAS float*)(lds + RING_OFF + wave * 16384);
        for (int it = gw; it < 16 * 12; it += NGW) {
            const int kc = it / 12, nc = it % 12; const int k = kc * 64 + lane;
#pragma unroll
            for (int v = 0; v < 9; ++v) { const float cv = (v < 8) ? args.in[6][v * 1024 + k] : args.in[7][k]; scr[v * 64 + lane] = cv * pg8::sigmoidf_(cv); }
            LDS_WAIT(); asm volatile("" ::: "memory");
            f32x4 acc[9];
#pragma unroll
            for (int v = 0; v < 9; ++v) acc[v] = (f32x4){0.f, 0.f, 0.f, 0.f};
            const float* wp = args.in[8] + (size_t)(kc * 64) * 3072 + nc * 256 + lane * 4;
#pragma unroll 4
            for (int kk = 0; kk < 64; ++kk) { const f32x4 w = *(const f32x4*)(wp + (size_t)kk * 3072);
#pragma unroll
                for (int v = 0; v < 9; ++v) acc[v] += w * scr[v * 64 + kk]; }
#pragma unroll
            for (int v = 0; v < 9; ++v) *(f32x4*)(MODP + (size_t)(kc * 9 + v) * 3072 + nc * 256 + lane * 4) = acc[v];
            LDS_WAIT(); asm volatile("" ::: "memory");
        }
        constexpr int I_IN = 16 * (DIN / 32), I_BR = 8 * 32, I_OUT = 16 * 32, NITEMS = I_IN + 2 * I_BR + I_OUT;
        for (int it = gw; it < NITEMS; it += NGW) {
            int r = it;
            if (r < I_IN) { transpose_item(args.in[10], 1024, DIN, WIN, scr, r, lane, true); continue; } r -= I_IN;
            if (r < I_BR) { transpose_item(args.in[13], 512, 1024, WBA, scr, r, lane, false); continue; } r -= I_BR;
            if (r < I_BR) { transpose_item(args.in[14], 512, 1024, WBB, scr, r, lane, false); continue; } r -= I_BR;
            transpose_item(args.in[15], 1024, 1024, WOUT, scr, r, lane, false);
        }
        { constexpr int NA = 8 * 512 * 512 / 8, NB = 8 * 512 * 128 / 8;
          for (int i = gw * 64 + lane; i < 2 * NA + 2 * NB; i += NGW * 64) {
              const float* src; bf16* dst; int j = i;
              if (j < NA) { src = args.in[2]; dst = (bf16*)(ws + WS_CAK); } else if ((j -= NA) < NA) { src = args.in[3]; dst = (bf16*)(ws + WS_CAV); }
              else if ((j -= NA) < NB) { src = args.in[4]; dst = (bf16*)(ws + WS_CBK); } else { j -= NB; src = args.in[5]; dst = (bf16*)(ws + WS_CBV); }
              const f32x4 a = *(const f32x4*)(src + (size_t)j * 8), b = *(const f32x4*)(src + (size_t)j * 8 + 4);
              v4u o; o.x = pk2(a[0], a[1]); o.y = pk2(a[2], a[3]); o.z = pk2(b[0], b[1]); o.w = pk2(b[2], b[3]); *(v4u*)(dst + (size_t)j * 8) = o; } }
        if (bx == 0) { for (int i = tid; i < 64 * 16; i += NWAVES * 64) { const int pos = i >> 4, f = i & 15; const float inv = powf(10000.0f, -(float)(2 * f) / 32.0f); const float ang = (float)pos * inv;
            ROPE[2 * i] = cosf(ang); ROPE[2 * i + 1] = sinf(ang); } }
        if (BOTH(0)) GRID_BAR();
    }

    if (IN(1)) {
        LAS float* SH = (LAS float*)(lds + RING_OFF); LAS float* SC = SH + 1024;
        const float* b_ada = args.in[9];
        for (int blk = bx; blk < 256; blk += G) {
            const int v = blk < 128 ? 8 : ((blk - 128) >> 4);
            for (int n = tid; n < 2048; n += NWAVES * 64) { float s = b_ada[n];
#pragma unroll
                for (int kc = 0; kc < 16; ++kc) s += MODP[(size_t)(kc * 9 + v) * 3072 + n];
                if (n < 1024) SH[n] = s; else SC[n - 1024] = 1.0f + s; }
            if (blk < 9) { for (int n = tid; n < 3072; n += NWAVES * 64) { float s = b_ada[n];
#pragma unroll
                for (int kc = 0; kc < 16; ++kc) s += MODP[(size_t)(kc * 9 + blk) * 3072 + n];
                MODF[(size_t)blk * 3072 + n] = s; } }
            __syncthreads();
            for (int rr = wave; rr < 64; rr += NWAVES) { const int m = blk * 64 + rr;
                const float* xrow = (m < MCTX) ? x_prompt + (size_t)m * DM : x_sample + (size_t)(m - MCTX) * DM;
                const GAS f32x4* xr = (const GAS f32x4*)xrow + lane;
                f32x4 xv[4]; float s2 = 0.f;
#pragma unroll
                for (int j = 0; j < 4; ++j) { xv[j] = xr[64 * j]; s2 += (xv[j].x * xv[j].x + xv[j].y * xv[j].y) + (xv[j].z * xv[j].z + xv[j].w * xv[j].w); }
                const float rstd = 1.0f / sqrtf(wave_sum(s2) * (1.0f / DM) + EPS);
                GAS unsigned long long* o8 = (GAS unsigned long long*)(HB + (size_t)m * DM) + lane;
#pragma unroll
                for (int j = 0; j < 4; ++j) { const f32x4 sc = *(const LAS f32x4*)(SC + 4 * lane + 256 * j), sh = *(const LAS f32x4*)(SH + 4 * lane + 256 * j);
                    const f32x4 hv = xv[j] * rstd * sc + sh;
                    o8[64 * j] = (unsigned long long)pk2(hv.x, hv.y) | ((unsigned long long)pk2(hv.z, hv.w) << 32); } }
            __syncthreads();
        }
        if (BOTH(1)) GRID_BAR();
    }

    if (IN(2)) {
        pg8::GemmCfg g{2048, 2048, 1024}; SchedInProj S{bx, G, (const char*)HB, (const char*)WIN};
        pg8::EpiInProj E{(bf16*)(ws + WS_QA), (bf16*)(ws + WS_KA), (bf16*)(ws + WS_VA), (bf16*)(ws + WS_ZA), (bf16*)(ws + WS_QB), (bf16*)(ws + WS_KB), (bf16*)(ws + WS_VB), (bf16*)(ws + WS_ZB),
                         (bf16*)(ws + WS_GA), (bf16*)(ws + WS_GB), args.out + 16777216, args.out + 20971520, args.out + 25165824, args.out + 26214400, ROPE};
        pg8::gemm_phase<pg8::EpiInProj, SchedInProj, true>(lds + RING_OFF, g, S, E);
        if (BOTH(2)) GRID_BAR();
    }

    if (IN(3)) {
        att::AttnP P{(bf16*)(ws + WS_QA), (bf16*)(ws + WS_ZA), (bf16*)(ws + WS_QB), (bf16*)(ws + WS_ZB), (const bf16*)(ws + WS_KA), (const bf16*)(ws + WS_VA), (const bf16*)(ws + WS_KB), (const bf16*)(ws + WS_VB),
                     (const bf16*)(ws + WS_CAK), (const bf16*)(ws + WS_CAV), (const bf16*)(ws + WS_CBK), (const bf16*)(ws + WS_CBV), args.in[11], args.in[12]};
        for (int u = vcu; u < 256; u += G) {
            for (int i = 0; i < 4; ++i) {
                int kind, b, h, x;
                if (i == 0) { kind = 2; b = u >> 5; h = (u >> 2) & 7; x = u & 3; }
                else if (i == 1) { const int bk = (u >> 4) & 15, q = (u >> 2) & 3, rg = u & 3; kind = 3; b = bk >> 1; h = bk & 1;
                    x = (rg == 1) ? (q == 0 ? 0 : q == 1 ? 15 : q) : (rg == 2) ? (q == 0 ? 1 : q == 1 ? 14 : q + 2) : (rg == 0) ? 6 + q : 10 + q; }
                else if (i == 2) { kind = 0; b = u >> 3; h = u & 7; x = 0; }
                else { kind = 1; b = u >> 3; h = (u >> 2) & 1; x = u & 3; }
#ifndef ATT_KINDS
#define ATT_KINDS 0xf
#endif
                if ((ATT_KINDS >> kind) & 1) att::attn_unit(P, kind, b, h, x, lds + RING_OFF);
            }
        }
        if (BOTH(3)) GRID_BAR();
    }

    if (IN(4)) {
        for (int c = bx; c < 256; c += G) {
            pg8::GemmCfg g{1024, 1024, 512}; SchedMerge S{c, (const char*)(ws + WS_QA), (const char*)(ws + WS_QB), (const char*)WBA, (const char*)WBB};
            pg8::EpiMerge E{(const bf16*)(ws + WS_GA), (const bf16*)(ws + WS_GB), args.out, HB};
            pg8::gemm_phase<pg8::EpiMerge, SchedMerge, true>(lds + RING_OFF, g, S, E);
        }
        if (BOTH(4)) GRID_BAR();
    }

    if (IN(5)) {
        for (int c = bx; c < 256; c += G) {
            pg8::GemmCfg g{2048, 2048, 1024}; SchedOut S{c, (const char*)HB, (const char*)WOUT};
            pg8::EpiOut E{x_prompt, x_sample, MODF, args.out};
            pg8::gemm_phase<pg8::EpiOut, SchedOut, false>(lds + RING_OFF, g, S, E);
        }
        if (BOTH(5)) GRID_BAR();
    }

    if (IN(6)) {
        const float* gn = args.in[16];
        f32x4 gv[4];
#pragma unroll
        for (int j = 0; j < 4; ++j) gv[j] = *(const f32x4*)(gn + 4 * lane + 256 * j);
        for (int m = gw; m < MROWS; m += NGW) {
            GAS f32x4* yr = (GAS f32x4*)(args.out + (size_t)m * DM) + lane;
            f32x4 xv[4]; float s2 = 0.f;
#pragma unroll
            for (int j = 0; j < 4; ++j) { xv[j] = yr[64 * j]; s2 += (xv[j].x * xv[j].x + xv[j].y * xv[j].y) + (xv[j].z * xv[j].z + xv[j].w * xv[j].w); }
            const float rstd = 1.0f / sqrtf(wave_sum(s2) * (1.0f / DM) + EPS);
#pragma unroll
            for (int j = 0; j < 4; ++j) yr[64 * j] = xv[j] * rstd * gv[j];
        }
    }
#undef IN
#undef BOTH
#undef GRID_BAR
}

extern "C" void kernel_launch(void* const* d_in, const int* in_sizes, int n_in, void* d_out, int out_size, void* d_ws, size_t ws_size, hipStream_t stream) {
    static int grid = 0;
    if (grid == 0) {
        if (n_in != 17 || out_size != 27262976 || ws_size < WS_END) { fprintf(stderr, "kernel_launch: unexpected problem (n_in %d out %d ws %zu)\n", n_in, out_size, ws_size); grid = -1; return; }
        int dev = 0, cus = 0, per_cu = 0;
        if (hipGetDevice(&dev) != hipSuccess || hipDeviceGetAttribute(&cus, hipDeviceAttributeMultiprocessorCount, dev) != hipSuccess) { grid = -1; return; }
        bool okk = true;
#define SETUP_K(L, H) okk = okk && (hipFuncSetAttribute((const void*)fwd_kernel<L, H>, hipFuncAttributeMaxDynamicSharedMemorySize, LDS_BYTES) == hipSuccess)
        #if MK_N_LAUNCHES == 7
        SETUP_K(0, 1); SETUP_K(1, 2); SETUP_K(2, 3); SETUP_K(3, 4); SETUP_K(4, 5); SETUP_K(5, 6); SETUP_K(6, 7);
#else
        SETUP_K(0, 7);
#endif
        if (!okk) { fprintf(stderr, "kernel_launch: hipFuncSetAttribute failed\n"); grid = -1; return; }
        (void)hipGetLastError();
        grid = cus;
    }
    if (grid < 0) return;
    (void)hipMemsetAsync((char*)d_ws + WS_CTL, 0, CTL_ZERO_BYTES, stream);
    Args a{};
    for (int i = 0; i < 17; ++i) a.in[i] = (const float*)d_in[i];
    a.out = (float*)d_out; a.ws = (unsigned char*)d_ws;
#define LAUNCH_K(L, H) do { a.ph_lo = L; a.ph_hi = H; a.li = L; hipLaunchKernelGGL((fwd_kernel<L, H>), dim3(grid), dim3(NWAVES * 64), LDS_BYTES, stream, a); } while (0)
#if MK_N_LAUNCHES == 7
    LAUNCH_K(0, 1); LAUNCH_K(1, 2); LAUNCH_K(2, 3); LAUNCH_K(3, 4); LAUNCH_K(4, 5); LAUNCH_K(5, 6); LAUNCH_K(6, 7);
#else
    LAUNCH_K(0, 7);
#endif
}
```
